# Optimizing an MI355X kernel written in HIP

```python
import math
import jax
import jax.numpy as jnp
from jax import lax
import numpy as np

D_MODEL = 1024
BATCH = 32
SEQ = 256
DEPTH = 1
DEC_BATCH = 2
DEC_SEQ = 1024
PAST_LEN = 256

GRID_W = 64
ATT_WIDTH = D_MODEL // 2
HY_WIDTH = D_MODEL - ATT_WIDTH
MIX_WIDTH = ATT_WIDTH + HY_WIDTH
DA_HEADS = 4
DA_HEAD_DIM = ATT_WIDTH // (2 * DA_HEADS)
HY_ORDER = 2
HY_EMB_DIM = 33
HY_BANDS = (HY_EMB_DIM - 1) // 2
HY_FILTER_WIDTH = 64
HY_DECAY_TARGET = 1e-2
HY_SHORT_PCT = 0.3
HY_LONG_PCT = 1.5
IN_COLS = 3 * ATT_WIDTH + 3 * HY_WIDTH
D_FF = -(-8 * D_MODEL // (3 * 256)) * 256
DEEPNORM_ALPHA = (2.0 * DEPTH) ** 0.25
DEEPNORM_BETA = (8.0 * DEPTH) ** -0.25
ROPE_BASE = 10000.0
LN_EPS = 1e-5
Q_BLOCK = 128

kernel_name = 'hybrid_diffattn_hyena_prefix_dit_step'


def layer_norm(x, g=None, b=None):
    xf = x.astype(jnp.float32)
    mu = jnp.mean(xf, axis=-1, keepdims=True)
    var = jnp.mean(jnp.square(xf - mu), axis=-1, keepdims=True)
    y = (xf - mu) * lax.rsqrt(var + LN_EPS)
    if g is not None:
        y = y * g.astype(jnp.float32) + b.astype(jnp.float32)
    return y.astype(x.dtype)


def rms_norm(x, g):
    xf = x.astype(jnp.float32)
    return xf * lax.rsqrt(jnp.mean(xf * xf, axis=-1, keepdims=True) + LN_EPS) * g.astype(jnp.float32)


def adaln_params(cvec, w, b):
    m = jax.nn.silu(cvec) @ w + b
    return jnp.split(m[..., None, :], 6, axis=-1)


def axial_rope_tables(n):
    rows = n // GRID_W
    pos = jnp.arange(rows * GRID_W)
    row = (pos // GRID_W).astype(jnp.float32)
    col = (pos % GRID_W).astype(jnp.float32)
    half = DA_HEAD_DIM // 2
    inv = ROPE_BASE ** (-jnp.arange(0, half, 2, dtype=jnp.float32) / half)
    ang = jnp.stack([row[:, None] * inv, col[:, None] * inv], axis=1)
    return jnp.cos(ang), jnp.sin(ang)


def apply_axial_rope(x, cos, sin):
    xs = x.astype(jnp.float32).reshape(x.shape[:-1] + (2, 2, DA_HEAD_DIM // 4))
    x1, x2 = xs[..., 0, :], xs[..., 1, :]
    c_, s_ = cos[None, :, None], sin[None, :, None]
    out = jnp.stack([x1 * c_ - x2 * s_, x1 * s_ + x2 * c_], axis=-2)
    return out.reshape(x.shape).astype(x.dtype)


def diff_attention(q, k, v, lam):
    B, n = q.shape[:2]
    nblk = n // Q_BLOCK
    qb = q.reshape(B, nblk, Q_BLOCK, 2 * DA_HEADS, DA_HEAD_DIM).transpose(1, 0, 2, 3, 4)
    kf = k.astype(jnp.float32)
    vf = v.astype(jnp.float32)
    scale = DA_HEAD_DIM ** -0.5

    def block(qblk):
        s = jnp.einsum('bqhd,bkhd->bhqk', qblk.astype(jnp.float32), kf) * scale
        p = jax.nn.softmax(s, axis=-1).reshape(B, DA_HEADS, 2, Q_BLOCK, -1)
        a = p[:, :, 0] - lam * p[:, :, 1]
        return jnp.einsum('bhqk,bkhe->bqhe', a, vf)

    o = lax.map(block, qb)
    return o.transpose(1, 0, 2, 3, 4).reshape(B, n, DA_HEADS, 2 * DA_HEAD_DIM)


def short_conv(u, w, b):
    n = u.shape[1]
    up = jnp.pad(u, ((0, 0), (1, 1), (0, 0)))
    return up[:, :n] * w[0] + up[:, 1:n + 1] * w[1] + up[:, 2:] * w[2] + b


def hyena_filters(n, w1, b1, w2, b2, freq, w3, decay):
    f32 = jnp.float32
    pos = jnp.arange(n, dtype=f32)
    t = (pos / (n - 1))[:, None]
    bands = jnp.linspace(1e-4, HY_BANDS - 1, HY_BANDS, dtype=f32)
    ang = (2.0 * math.pi / n) * pos[:, None] * bands
    z = jnp.concatenate([t, jnp.cos(ang), -jnp.sin(ang)], axis=-1)
    fr = freq.astype(f32)
    hdn = jnp.sin(fr * (z @ w1.astype(f32) + b1.astype(f32)))
    hdn = jnp.sin(fr * (hdn @ w2.astype(f32) + b2.astype(f32)))
    filt = (hdn @ w3.astype(f32)).reshape(n, HY_ORDER, 2, HY_WIDTH)
    return filt * jnp.exp(-t[:, :, None, None] * jnp.abs(decay.astype(f32)))


def bidir_long_conv(u, h_fwd, h_bwd, skip):
    n = u.shape[1]
    circ = jnp.concatenate([h_fwd, jnp.zeros_like(h_fwd[:1]), h_bwd[:0:-1]], axis=0)
    hf = jnp.fft.rfft(circ, axis=0)
    uf = jnp.fft.rfft(u, n=2 * n, axis=1)
    y = jnp.fft.irfft(uf * hf[None], n=2 * n, axis=1)[:, :n]
    return y + u * skip


def hyena_mixer(u, conv_w, conv_b, w1, b1, w2, b2, freq, w3, decay, skip):
    f32 = jnp.float32
    n = u.shape[1]
    uc = short_conv(u.astype(f32), conv_w.astype(f32), conv_b.astype(f32))
    v, x1, x2 = jnp.split(uc, 3, axis=-1)
    filt = hyena_filters(n, w1, b1, w2, b2, freq, w3, decay)
    sk = skip.astype(f32)
    z = x1 * bidir_long_conv(v, filt[:, 0, 0], filt[:, 0, 1], sk[0])
    return x2 * bidir_long_conv(z, filt[:, 1, 0], filt[:, 1, 1], sk[1])


def setup_inputs(seed: int = 0) -> dict:
    key = jax.random.key(seed)
    ks = jax.random.split(key, 32)
    f32 = jnp.float32

    def nrm(k, shape, s):
        return s * jax.random.normal(k, shape, f32)

    decay_lo = -math.log(HY_DECAY_TARGET) / HY_LONG_PCT
    decay_hi = -math.log(HY_DECAY_TARGET) / HY_SHORT_PCT
    base_decay = jnp.broadcast_to(jnp.linspace(decay_lo, decay_hi, HY_WIDTH, dtype=f32),
                                  (DEPTH, HY_ORDER, 2, HY_WIDTH))
    return {
        'x_prompt': nrm(ks[0], (BATCH, SEQ, D_MODEL), 1.0),
        'x_sample': nrm(ks[1], (DEC_BATCH, DEC_SEQ, D_MODEL), 1.0),
        'cache_k': nrm(ks[2], (DEC_BATCH, DEPTH, PAST_LEN, 2 * DA_HEADS, DA_HEAD_DIM), 1.0),
        'cache_v': nrm(ks[3], (DEC_BATCH, DEPTH, PAST_LEN, DA_HEADS, 2 * DA_HEAD_DIM), 1.0),
        'c': nrm(ks[4], (DEC_BATCH, D_MODEL), 1.0),
        'c_ctx': nrm(ks[5], (D_MODEL,), 1.0),
        'mod_w': nrm(ks[6], (DEPTH, D_MODEL, 6 * D_MODEL), 0.5 * D_MODEL ** -0.5),
        'mod_b': nrm(ks[7], (DEPTH, 6 * D_MODEL), 0.01),
        'w_in': nrm(ks[8], (DEPTH, D_MODEL, IN_COLS), D_MODEL ** -0.5),
        'da_lq1': nrm(ks[9], (DEPTH, DA_HEAD_DIM), 0.1),
        'da_lk1': nrm(ks[10], (DEPTH, DA_HEAD_DIM), 0.1),
        'da_lq2': nrm(ks[11], (DEPTH, DA_HEAD_DIM), 0.1),
        'da_lk2': nrm(ks[12], (DEPTH, DA_HEAD_DIM), 0.1),
        'da_subln': 1.0 + nrm(ks[13], (DEPTH, 2 * DA_HEAD_DIM), 0.01),
        'hy_conv_w': nrm(ks[14], (DEPTH, 3, 3 * HY_WIDTH), 3 ** -0.5),
        'hy_conv_b': nrm(ks[15], (DEPTH, 3 * HY_WIDTH), 0.01),
        'hy_w1': nrm(ks[16], (DEPTH, HY_EMB_DIM, HY_FILTER_WIDTH), HY_EMB_DIM ** -0.5),
        'hy_b1': nrm(ks[17], (DEPTH, HY_FILTER_WIDTH), 0.01),
        'hy_w2': nrm(ks[18], (DEPTH, HY_FILTER_WIDTH, HY_FILTER_WIDTH), HY_FILTER_WIDTH ** -0.5),
        'hy_b2': nrm(ks[19], (DEPTH, HY_FILTER_WIDTH), 0.01),
        'hy_freq': 1.0 + nrm(ks[20], (DEPTH, HY_FILTER_WIDTH), 0.01),
        'hy_w3': nrm(ks[21], (DEPTH, HY_FILTER_WIDTH, HY_ORDER * 2 * HY_WIDTH), 0.1 * HY_FILTER_WIDTH ** -0.5),
        'hy_decay': base_decay + nrm(ks[22], (DEPTH, HY_ORDER, 2, HY_WIDTH), 0.1),
        'hy_skip': nrm(ks[23], (DEPTH, HY_ORDER, HY_WIDTH), 1.0),
        'w_out': nrm(ks[24], (DEPTH, MIX_WIDTH, D_MODEL), DEEPNORM_BETA * MIX_WIDTH ** -0.5),
        'ln1_g': 1.0 + nrm(ks[25], (DEPTH, D_MODEL), 0.01),
        'ln1_b': nrm(ks[26], (DEPTH, D_MODEL), 0.01),
        'w_up': nrm(ks[27], (DEPTH, D_MODEL, 2 * D_FF), D_MODEL ** -0.5),
        'w_down': nrm(ks[28], (DEPTH, D_FF, D_MODEL), DEEPNORM_BETA * D_FF ** -0.5),
        'ln2_g': 1.0 + nrm(ks[29], (DEPTH, D_MODEL), 0.01),
        'ln2_b': nrm(ks[30], (DEPTH, D_MODEL), 0.01),
    }


def reference(x_prompt, x_sample, cache_k, cache_v, c, c_ctx, mod_w, mod_b, w_in,
              da_lq1, da_lk1, da_lq2, da_lk2, da_subln, hy_conv_w, hy_conv_b,
              hy_w1, hy_b1, hy_w2, hy_b2, hy_freq, hy_w3, hy_decay, hy_skip,
              w_out, ln1_g, ln1_b, w_up, w_down, ln2_g, ln2_b):

    def layer(x, cvec, ctx_k, ctx_v, li, latent):
        B, n, _ = x.shape
        sh1, sc1, g1, sh2, sc2, g2 = adaln_params(cvec, mod_w[li], mod_b[li])
        h = layer_norm(x) * (1 + sc1) + sh1
        proj = h @ w_in[li]
        q, k, v, hy_in = jnp.split(proj, [ATT_WIDTH, 2 * ATT_WIDTH, 3 * ATT_WIDTH], axis=-1)
        q = q.reshape(B, n, 2 * DA_HEADS, DA_HEAD_DIM)
        k = k.reshape(B, n, 2 * DA_HEADS, DA_HEAD_DIM)
        v = v.reshape(B, n, DA_HEADS, 2 * DA_HEAD_DIM)
        if latent:
            cos, sin = axial_rope_tables(n)
            q = apply_axial_rope(q, cos, sin)
            keys = jnp.concatenate([ctx_k, apply_axial_rope(k, cos, sin)], axis=1)
            vals = jnp.concatenate([ctx_v, v], axis=1)
        else:
            keys, vals = k, v
        lam_init = 0.8 - 0.6 * math.exp(-0.3 * li)
        lam = (jnp.exp(jnp.sum(da_lq1[li].astype(jnp.float32) * da_lk1[li].astype(jnp.float32)))
               - jnp.exp(jnp.sum(da_lq2[li].astype(jnp.float32) * da_lk2[li].astype(jnp.float32)))
               + lam_init)
        att = diff_attention(q, keys, vals, lam)
        att = (rms_norm(att, da_subln[li]) * (1 - lam_init)).reshape(B, n, ATT_WIDTH).astype(x.dtype)
        hy = hyena_mixer(hy_in, hy_conv_w[li], hy_conv_b[li], hy_w1[li], hy_b1[li], hy_w2[li],
                         hy_b2[li], hy_freq[li], hy_w3[li], hy_decay[li], hy_skip[li]).astype(x.dtype)
        mix = jnp.concatenate([att, hy], axis=-1) @ w_out[li]
        x = layer_norm(DEEPNORM_ALPHA * x + g1 * mix, ln1_g[li], ln1_b[li])
        h = layer_norm(x) * (1 + sc2) + sh2
        gate, up = jnp.split(h @ w_up[li], 2, axis=-1)
        ffn = (jax.nn.silu(gate) * up) @ w_down[li]
        x = layer_norm(DEEPNORM_ALPHA * x + g2 * ffn, ln2_g[li], ln2_b[li])
        return x, k, v

    y_prompt = x_prompt
    ks_new, vs_new = [], []
    for li in range(DEPTH):
        y_prompt, k_l, v_l = layer(y_prompt, c_ctx, None, None, li, False)
        ks_new.append(k_l)
        vs_new.append(v_l)
    new_cache_k = jnp.stack(ks_new, axis=1)
    new_cache_v = jnp.stack(vs_new, axis=1)

    y_sample = x_sample
    for li in range(DEPTH):
        y_sample, _, _ = layer(y_sample, c, cache_k[:, li], cache_v[:, li], li, True)

    return (y_prompt, y_sample, new_cache_k, new_cache_v)
```

```cpp
#include <hip/hip_runtime.h>
#include <cstdio>
#include <cstdint>
namespace nv {
constexpr int D = 1024, NIN = 3072, DFF = 2816, CH = 2048;
constexpr float ALPHA = 1.189207115002721f;
constexpr float EPS = 1e-5f;

__global__ void k_mod(const float* c, const float* cctx, const float* W, const float* bias, float* mod) {
    int j = blockIdx.x * blockDim.x + threadIdx.x; int cv = blockIdx.y;
    if (j >= 6144) return;
    const float* cvp = cv == 0 ? cctx : c + (cv - 1) * D;
    float acc = 0.f;
    for (int k = 0; k < D; ++k) { float v = cvp[k]; float s = v / (1.f + expf(-v)); acc += s * W[(size_t)k * 6144 + j]; }
    mod[cv * 6144 + j] = acc + bias[j];
}
__global__ void k_lnmod(const float* x, const float* mod, int cv0, int rows_per_cv, int shiftIdx, int scaleIdx, float* out) {
    int r = blockIdx.x; const float* xr = x + (size_t)r * D; int cv = cv0 + r / rows_per_cv;
    __shared__ float red[256];
    float s = 0.f; for (int i = threadIdx.x; i < D; i += 256) s += xr[i];
    red[threadIdx.x] = s; __syncthreads();
    for (int o = 128; o > 0; o >>= 1) { if (threadIdx.x < o) red[threadIdx.x] += red[threadIdx.x + o]; __syncthreads(); }
    float mean = red[0] / D; __syncthreads();
    float q = 0.f; for (int i = threadIdx.x; i < D; i += 256) { float d = xr[i] - mean; q += d * d; }
    red[threadIdx.x] = q; __syncthreads();
    for (int o = 128; o > 0; o >>= 1) { if (threadIdx.x < o) red[threadIdx.x] += red[threadIdx.x + o]; __syncthreads(); }
    float rstd = rsqrtf(red[0] / D + EPS);
    const float* sh = mod + cv * 6144 + shiftIdx * D; const float* sc = mod + cv * 6144 + scaleIdx * D;
    for (int i = threadIdx.x; i < D; i += 256) out[(size_t)r * D + i] = (xr[i] - mean) * rstd * (1.f + sc[i]) + sh[i];
}
__global__ void k_lnres(const float* x, const float* y, const float* mod, int cv0, int rows_per_cv, int gateIdx, const float* g, const float* b, float* out) {
    int r = blockIdx.x; int cv = cv0 + r / rows_per_cv; const float* gt = mod + cv * 6144 + gateIdx * D;
    __shared__ float red[256]; __shared__ float v[D];
    float s = 0.f; for (int i = threadIdx.x; i < D; i += 256) { float t = ALPHA * x[(size_t)r * D + i] + gt[i] * y[(size_t)r * D + i]; v[i] = t; s += t; }
    red[threadIdx.x] = s; __syncthreads();
    for (int o = 128; o > 0; o >>= 1) { if (threadIdx.x < o) red[threadIdx.x] += red[threadIdx.x + o]; __syncthreads(); }
    float mean = red[0] / D; __syncthreads();
    float q = 0.f; for (int i = threadIdx.x; i < D; i += 256) { float d = v[i] - mean; q += d * d; }
    red[threadIdx.x] = q; __syncthreads();
    for (int o = 128; o > 0; o >>= 1) { if (threadIdx.x < o) red[threadIdx.x] += red[threadIdx.x + o]; __syncthreads(); }
    float rstd = rsqrtf(red[0] / D + EPS);
    for (int i = threadIdx.x; i < D; i += 256) out[(size_t)r * D + i] = (v[i] - mean) * rstd * g[i] + b[i];
}
__global__ void k_gemm(const float* A, const float* B, float* C, int M, int N, int K) {
    __shared__ float As[16][65]; __shared__ float Bs[16][65];
    int tx = threadIdx.x % 16, ty = threadIdx.x / 16; int m0 = blockIdx.y * 64, n0 = blockIdx.x * 64;
    float acc[4][4] = {};
    for (int k0 = 0; k0 < K; k0 += 16) {
        for (int i = threadIdx.x; i < 1024; i += 256) { int r = i / 16, kk = i % 16; As[kk][r] = A[(size_t)(m0 + r) * K + k0 + kk]; }
        for (int i = threadIdx.x; i < 1024; i += 256) { int kk = i / 64, cc = i % 64; Bs[kk][cc] = B[(size_t)(k0 + kk) * N + n0 + cc]; }
        __syncthreads();
#pragma unroll
        for (int kk = 0; kk < 16; ++kk) { float a[4], b[4];
#pragma unroll
            for (int i = 0; i < 4; ++i) { a[i] = As[kk][ty * 4 + i]; b[i] = Bs[kk][tx * 4 + i]; }
#pragma unroll
            for (int i = 0; i < 4; ++i)
#pragma unroll
                for (int j = 0; j < 4; ++j) acc[i][j] += a[i] * b[j]; }
        __syncthreads();
    }
    for (int i = 0; i < 4; ++i) for (int j = 0; j < 4; ++j) C[(size_t)(m0 + ty * 4 + i) * N + n0 + tx * 4 + j] = acc[i][j];
}
__global__ void k_split(const float* proj, int latent, const float* cache_k, const float* cache_v, float* q, float* kb, float* vb, float* outk, float* outv) {
    int r = blockIdx.x;
    for (int c = threadIdx.x; c < 512; c += blockDim.x) {
        float qv = proj[(size_t)r * NIN + c], kv = proj[(size_t)r * NIN + 512 + c], vv = proj[(size_t)r * NIN + 1024 + c];
        if (!latent) { q[(size_t)r * 512 + c] = qv; kb[(size_t)r * 512 + c] = kv; vb[(size_t)r * 512 + c] = vv; outk[(size_t)r * 512 + c] = kv; outv[(size_t)r * 512 + c] = vv; }
        else {
            int b = r / 1024, t = r % 1024; int d = c % 64; int axis = d / 32, half = (d % 32) / 16, i = d % 16;
            float pos = axis == 0 ? (float)(t / 64) : (float)(t % 64);
            float inv = powf(10000.f, -(float)(2 * i) / 32.f); float ang = pos * inv; float cs = cosf(ang), sn = sinf(ang);
            int cp = half == 0 ? c + 16 : c - 16;
            float qo = proj[(size_t)r * NIN + cp], ko = proj[(size_t)r * NIN + 512 + cp];
            float qr = half == 0 ? qv * cs - qo * sn : qo * sn + qv * cs;
            float kr = half == 0 ? kv * cs - ko * sn : ko * sn + kv * cs;
            q[(size_t)r * 512 + c] = qr; kb[((size_t)b * 1280 + 256 + t) * 512 + c] = kr; vb[((size_t)b * 1280 + 256 + t) * 512 + c] = vv;
        }
    }
    if (latent && r < 512) {
        int b = r / 256, key = r % 256;
        for (int c = threadIdx.x; c < 512; c += blockDim.x) { kb[((size_t)b * 1280 + key) * 512 + c] = cache_k[((size_t)b * 256 + key) * 512 + c]; vb[((size_t)b * 1280 + key) * 512 + c] = cache_v[((size_t)b * 256 + key) * 512 + c]; }
    }
}
__global__ void k_attn(const float* q, const float* kb, const float* vb, int nq, int NK, const float* lq1, const float* lk1, const float* lq2, const float* lk2, const float* subln, float* mixin) {
    int r = blockIdx.x, hp = blockIdx.y; int b = r / nq; int tid = threadIdx.x;
    __shared__ float sc[2][1280]; __shared__ float red[128]; __shared__ float lam_s;
    if (tid == 0) { float a = 0.f, c2 = 0.f; for (int i = 0; i < 64; ++i) { a += lq1[i] * lk1[i]; c2 += lq2[i] * lk2[i]; } lam_s = expf(a) - expf(c2) + 0.2f; }
    const float* kbase = kb + (size_t)b * NK * 512; const float* vbase = vb + (size_t)b * NK * 512;
    for (int hh = 0; hh < 2; ++hh) {
        const float* qr = q + (size_t)r * 512 + (2 * hp + hh) * 64;
        for (int k = tid; k < NK; k += 128) { const float* kr = kbase + (size_t)k * 512 + (2 * hp + hh) * 64; float s = 0.f; for (int d = 0; d < 64; ++d) s += qr[d] * kr[d]; sc[hh][k] = s * 0.125f; }
        __syncthreads();
        float m = -1e30f; for (int k = tid; k < NK; k += 128) m = fmaxf(m, sc[hh][k]);
        red[tid] = m; __syncthreads();
        for (int o = 64; o > 0; o >>= 1) { if (tid < o) red[tid] = fmaxf(red[tid], red[tid + o]); __syncthreads(); }
        m = red[0]; __syncthreads();
        float l = 0.f; for (int k = tid; k < NK; k += 128) { float e = expf(sc[hh][k] - m); sc[hh][k] = e; l += e; }
        red[tid] = l; __syncthreads();
        for (int o = 64; o > 0; o >>= 1) { if (tid < o) red[tid] += red[tid + o]; __syncthreads(); }
        l = red[0]; __syncthreads();
        for (int k = tid; k < NK; k += 128) sc[hh][k] /= l;
        __syncthreads();
    }
    float lam = lam_s; float o = 0.f;
    for (int k = 0; k < NK; ++k) o += (sc[0][k] - lam * sc[1][k]) * vbase[(size_t)k * 512 + hp * 128 + tid];
    red[tid] = o * o; __syncthreads();
    for (int s = 64; s > 0; s >>= 1) { if (tid < s) red[tid] += red[tid + s]; __syncthreads(); }
    float rr = rsqrtf(red[0] / 128.f + EPS);
    mixin[(size_t)r * D + hp * 128 + tid] = o * rr * subln[tid] * 0.8f;
}
__global__ void k_filt(int n, const float* w1, const float* b1, const float* w2, const float* b2, const float* freq, const float* w3, const float* decay, float* filt) {
    int p = blockIdx.x; int col = blockIdx.y * 256 + threadIdx.x;
    __shared__ float z[33], h1[64], h2[64];
    float t = (float)p / (float)(n - 1);
    if (threadIdx.x < 33) { int i = threadIdx.x; float v;
        if (i == 0) v = t; else { int bi = (i - 1) % 16; float band = 1e-4f + (float)bi * ((15.f - 1e-4f) / 15.f); float ang = (6.283185307179586f / (float)n) * (float)p * band; v = (i <= 16) ? cosf(ang) : -sinf(ang); }
        z[i] = v; }
    __syncthreads();
    if (threadIdx.x < 64) { int j = threadIdx.x; float a = b1[j]; for (int i = 0; i < 33; ++i) a += z[i] * w1[i * 64 + j]; h1[j] = sinf(freq[j] * a); }
    __syncthreads();
    if (threadIdx.x < 64) { int j = threadIdx.x; float a = b2[j]; for (int i = 0; i < 64; ++i) a += h1[i] * w2[i * 64 + j]; h2[j] = sinf(freq[j] * a); }
    __syncthreads();
    float a = 0.f; for (int i = 0; i < 64; ++i) a += h2[i] * w3[i * 2048 + col];
    filt[(size_t)p * 2048 + col] = a * expf(-t * fabsf(decay[col]));
}
__global__ void k_sconv(const float* proj, int n, const float* cw, const float* cb, float* uc) {
    int r = blockIdx.x; int t = r % n;
    for (int c = threadIdx.x; c < 1536; c += blockDim.x) {
        float u0 = proj[(size_t)r * NIN + 1536 + c];
        float um = t > 0 ? proj[(size_t)(r - 1) * NIN + 1536 + c] : 0.f;
        float up = t < n - 1 ? proj[(size_t)(r + 1) * NIN + 1536 + c] : 0.f;
        uc[(size_t)r * 1536 + c] = um * cw[c] + u0 * cw[1536 + c] + up * cw[3072 + c] + cb[c];
    }
}
__global__ void k_lconv(const float* in, int in_pitch, int in_off, const float* mul, int mul_off, int n, const float* filt, int order, const float* skip, float* out, int out_pitch, int out_off) {
    int r = blockIdx.x; int t = r % n; int base = r - t; int c = threadIdx.x;
    const float* hf = filt + (size_t)(order * 2 + 0) * 512 + c; const float* hb = filt + (size_t)(order * 2 + 1) * 512 + c;
    float acc = 0.f;
    for (int s = 0; s < n; ++s) { float u = in[(size_t)(base + s) * in_pitch + in_off + c]; float g = s <= t ? hf[(size_t)(t - s) * 2048] : hb[(size_t)(s - t) * 2048]; acc += g * u; }
    acc += skip[order * 512 + c] * in[(size_t)r * in_pitch + in_off + c];
    out[(size_t)r * out_pitch + out_off + c] = mul[(size_t)r * 1536 + mul_off + c] * acc;
}
__global__ void k_swiglu(const float* gu, float* act) {
    int r = blockIdx.x;
    for (int c = threadIdx.x; c < DFF; c += blockDim.x) { float g = gu[(size_t)r * 2 * DFF + c], u = gu[(size_t)r * 2 * DFF + DFF + c]; act[(size_t)r * DFF + c] = g / (1.f + expf(-g)) * u; }
}

static void run(void* const* d_in, float* out, char* ws, hipStream_t st, float* dbg_mixin, float* dbg_x1) {
    const float* xp = (const float*)d_in[0]; const float* xs = (const float*)d_in[1];
    const float* ck = (const float*)d_in[2]; const float* cvv = (const float*)d_in[3];
    const float* c = (const float*)d_in[4]; const float* cctx = (const float*)d_in[5];
    const float* modw = (const float*)d_in[6]; const float* modb = (const float*)d_in[7]; const float* win = (const float*)d_in[8];
    const float *lq1 = (const float*)d_in[9], *lk1 = (const float*)d_in[10], *lq2 = (const float*)d_in[11], *lk2 = (const float*)d_in[12], *subln = (const float*)d_in[13];
    const float *hcw = (const float*)d_in[14], *hcb = (const float*)d_in[15], *hw1 = (const float*)d_in[16], *hb1 = (const float*)d_in[17], *hw2 = (const float*)d_in[18], *hb2 = (const float*)d_in[19];
    const float *hfreq = (const float*)d_in[20], *hw3 = (const float*)d_in[21], *hdecay = (const float*)d_in[22], *hskip = (const float*)d_in[23];
    const float *wout = (const float*)d_in[24], *ln1g = (const float*)d_in[25], *ln1b = (const float*)d_in[26], *wup = (const float*)d_in[27], *wdown = (const float*)d_in[28], *ln2g = (const float*)d_in[29], *ln2b = (const float*)d_in[30];
    size_t off = 0; auto take = [&](size_t bytes) { char* p = ws + off; off += (bytes + 255) & ~(size_t)255; return (float*)p; };
    float* mod = take(3 * 6144 * 4);
    float* filtC = take((size_t)256 * 2048 * 4); float* filtL = take((size_t)1024 * 2048 * 4);
    float* h = take((size_t)CH * D * 4); float* proj = take((size_t)CH * NIN * 4);
    float* q = take((size_t)CH * 512 * 4); float* kb = take((size_t)2 * 1280 * 512 * 4); float* vb = take((size_t)2 * 1280 * 512 * 4);
    float* uc = take((size_t)CH * 1536 * 4); float* z = take((size_t)CH * 1536 * 4);
    float* mixin = take((size_t)CH * D * 4); float* mix = take((size_t)CH * D * 4); float* x1 = take((size_t)CH * D * 4);
    float* gu = take((size_t)CH * 2 * DFF * 4); float* act = take((size_t)CH * DFF * 4); float* ffn = take((size_t)CH * D * 4);
    float* outk = out + (size_t)10240 * D; float* outv = outk + (size_t)8192 * 512;
    k_mod<<<dim3(24, 3), 256, 0, st>>>(c, cctx, modw, modb, mod);
    k_filt<<<dim3(256, 8), 256, 0, st>>>(256, hw1, hb1, hw2, hb2, hfreq, hw3, hdecay, filtC);
    k_filt<<<dim3(1024, 8), 256, 0, st>>>(1024, hw1, hb1, hw2, hb2, hfreq, hw3, hdecay, filtL);
    for (int ch = 0; ch < 5; ++ch) {
        const bool lat = ch == 4; const float* x = lat ? xs : xp + (size_t)ch * CH * D; const int n = lat ? 1024 : 256, NK = lat ? 1280 : 256;
        const int cv0 = lat ? 1 : 0, rpc = lat ? 1024 : CH; float* o = out + (size_t)ch * CH * D;
        k_lnmod<<<CH, 256, 0, st>>>(x, mod, cv0, rpc, 0, 1, h);
        k_gemm<<<dim3(NIN / 64, CH / 64), 256, 0, st>>>(h, win, proj, CH, NIN, D);
        k_split<<<CH, 256, 0, st>>>(proj, lat ? 1 : 0, ck, cvv, q, kb, vb, outk + (size_t)ch * CH * 512, outv + (size_t)ch * CH * 512);
        k_attn<<<dim3(CH, 4), 128, 0, st>>>(q, kb, vb, n, NK, lq1, lk1, lq2, lk2, subln, mixin);
        k_sconv<<<CH, 256, 0, st>>>(proj, n, hcw, hcb, uc);
        const float* filt = lat ? filtL : filtC;
        k_lconv<<<CH, 512, 0, st>>>(uc, 1536, 0, uc, 512, n, filt, 0, hskip, z, 512, 0);
        k_lconv<<<CH, 512, 0, st>>>(z, 512, 0, uc, 1024, n, filt, 1, hskip, mixin, D, 512);
        if (dbg_mixin) hipMemcpyAsync(dbg_mixin + (size_t)ch * CH * D, mixin, (size_t)CH * D * 4, hipMemcpyDeviceToDevice, st);
        k_gemm<<<dim3(D / 64, CH / 64), 256, 0, st>>>(mixin, wout, mix, CH, D, D);
        k_lnres<<<CH, 256, 0, st>>>(x, mix, mod, cv0, rpc, 2, ln1g, ln1b, x1);
        if (dbg_x1) hipMemcpyAsync(dbg_x1 + (size_t)ch * CH * D, x1, (size_t)CH * D * 4, hipMemcpyDeviceToDevice, st);
        k_lnmod<<<CH, 256, 0, st>>>(x1, mod, cv0, rpc, 3, 4, h);
        k_gemm<<<dim3(2 * DFF / 64, CH / 64), 256, 0, st>>>(h, wup, gu, CH, 2 * DFF, D);
        k_swiglu<<<CH, 256, 0, st>>>(gu, act);
        k_gemm<<<dim3(D / 64, CH / 64), 256, 0, st>>>(act, wdown, ffn, CH, D, DFF);
        k_lnres<<<CH, 256, 0, st>>>(x1, ffn, mod, cv0, rpc, 5, ln2g, ln2b, o);
    }
}
}
extern "C" void kernel_launch(void* const* d_in, const int* in_sizes, int n_in, void* d_out, int out_size, void* d_ws, size_t ws_size, hipStream_t stream) {
    nv::run(d_in, (float*)d_out, (char*)d_ws, stream, nullptr, nullptr);
}
```
